# Optimizing an MI355X kernel written in HIP

```python
import math
import jax, jax.numpy as jnp
from jax import lax
import numpy as np

D_MODEL = 1024
BATCH = 4
SEQ = 4096
DEPTH = 1

HEAD_DIM = 64
ROT_DIM = HEAD_DIM // 4
ROPE_THETA = 500000.0
QBLK = 128
DA_HEADS = 4
DA_V_DIM = 2 * HEAD_DIM
DA_QK_W = DA_HEADS * 2 * HEAD_DIM
DA_V_W = DA_HEADS * DA_V_DIM
DIL_PAIRS = ((128, 1), (512, 4), (2048, 16))
DIL_GROUPS = len(DIL_PAIRS)
DIL_HEADS = 8
DIL_W = DIL_HEADS * HEAD_DIM
IN_COLS = 2 * DA_QK_W + DA_V_W + 3 * DIL_GROUPS * DIL_W + 2 * D_MODEL
N_EXPERTS = 32
TOP_K = 4
D_FF = D_MODEL
SWIGLU_ALPHA = 1.702
SWIGLU_LIMIT = 7.0
MOE_BLK = 128
DN_ALPHA = (2 * DEPTH) ** 0.25
DN_BETA = (8 * DEPTH) ** -0.25
EPS = 1e-5

kernel_name = "hybrid_diffattn_dilated_moe_deepnorm"


def rope_tables(seq):
    inv_freq = ROPE_THETA ** (-jnp.arange(0, ROT_DIM, 2, dtype=jnp.float32) / ROT_DIM)
    ang = jnp.arange(seq, dtype=jnp.float32)[:, None] * inv_freq[None, :]
    return jnp.cos(ang), jnp.sin(ang)


def apply_rope(t, cos, sin):
    half = ROT_DIM // 2
    shp = (t.shape[1],) + (1,) * (t.ndim - 3) + (half,)
    c = cos.reshape(shp).astype(t.dtype)
    s = sin.reshape(shp).astype(t.dtype)
    t1 = t[..., :half]
    t2 = t[..., half:ROT_DIM]
    return jnp.concatenate([t1 * c - t2 * s, t2 * c + t1 * s, t[..., ROT_DIM:]], axis=-1)


def layer_norm(x, g, b):
    xf = x.astype(jnp.float32)
    mu = jnp.mean(xf, axis=-1, keepdims=True)
    var = jnp.mean(jnp.square(xf - mu), axis=-1, keepdims=True)
    y = (xf - mu) * lax.rsqrt(var + EPS) * g.astype(jnp.float32) + b.astype(jnp.float32)
    return y.astype(x.dtype)


def diff_attention(q, k, v, lam_q1, lam_k1, lam_q2, lam_k2, subln_g, lambda_init):
    B, S = q.shape[0], q.shape[1]
    qh = q.transpose(0, 2, 3, 1, 4) * (HEAD_DIM ** -0.5)
    kh = k.transpose(0, 2, 3, 1, 4)
    vh = v.transpose(0, 2, 1, 3)
    lam = (jnp.exp(jnp.sum(lam_q1.astype(jnp.float32) * lam_k1.astype(jnp.float32)))
           - jnp.exp(jnp.sum(lam_q2.astype(jnp.float32) * lam_k2.astype(jnp.float32)))
           + lambda_init)
    outs = []
    for i in range(S // QBLK):
        q0 = i * QBLK
        kend = q0 + QBLK
        s = jnp.einsum('bhcqd,bhckd->bhcqk', qh[:, :, :, q0:kend], kh[:, :, :, :kend]).astype(jnp.float32)
        mask = (q0 + jnp.arange(QBLK))[:, None] >= jnp.arange(kend)[None, :]
        p = jax.nn.softmax(jnp.where(mask, s, -jnp.inf), axis=-1)
        a = p[:, :, 0] - lam * p[:, :, 1]
        outs.append(jnp.einsum('bhqk,bhkv->bhqv', a.astype(v.dtype), vh[:, :, :kend]))
    o = jnp.concatenate(outs, axis=2).astype(jnp.float32)
    o = o * lax.rsqrt(jnp.mean(jnp.square(o), axis=-1, keepdims=True) + EPS) * subln_g.astype(jnp.float32)
    o = o * (1.0 - lambda_init)
    return o.astype(v.dtype).transpose(0, 2, 1, 3).reshape(B, S, DA_HEADS * DA_V_DIM)


def dilated_group(q, k, v, window, dilation):
    B, S, H, dh = q.shape
    rel = window // dilation
    L = S // dilation
    nb = -(-L // QBLK)
    Lp = nb * QBLK

    def strided(t):
        t = t.reshape(B, L, dilation, H, dh).transpose(0, 2, 3, 1, 4)
        return jnp.pad(t, ((0, 0), (0, 0), (0, 0), (0, Lp - L), (0, 0)))

    def banded(t):
        tb = t.reshape(B, dilation, H, nb, QBLK, dh)
        prev = jnp.pad(tb, ((0, 0), (0, 0), (0, 0), (1, 0), (0, 0), (0, 0)))[:, :, :, :nb]
        return jnp.concatenate([prev, tb], axis=4)

    qb = (strided(q) * (dh ** -0.5)).reshape(B, dilation, H, nb, QBLK, dh)
    kk = banded(strided(k))
    vv = banded(strided(v))
    s = jnp.einsum('bdhnqe,bdhnke->bdhnqk', qb, kk).astype(jnp.float32)
    qi = jnp.arange(QBLK)[:, None]
    kj = jnp.arange(2 * QBLK)[None, :]
    dist = qi + QBLK - kj
    blk = jnp.arange(nb)[:, None, None]
    mask = (dist >= 0) & (dist <= rel) & (blk * QBLK + kj - QBLK >= 0)
    s = jnp.where(mask, s, -jnp.inf)
    m = jnp.max(s, axis=-1, keepdims=True)
    p = jnp.exp(s - m)
    den = jnp.sum(p, axis=-1, keepdims=True)
    o = jnp.einsum('bdhnqk,bdhnke->bdhnqe', (p / den).astype(v.dtype), vv)
    lse = (m + jnp.log(den))[..., 0]
    o = o.reshape(B, dilation, H, Lp, dh)[:, :, :, :L].transpose(0, 3, 1, 2, 4).reshape(B, S, H, dh)
    lse = lse.reshape(B, dilation, H, Lp)[..., :L].transpose(0, 3, 1, 2).reshape(B, S, H)
    return o, lse


def token_mixer(h, w_in, b_gate, lam_q1, lam_k1, lam_q2, lam_k2, subln_g, w_oa, w_ob, w_o,
                cos, sin, lambda_init):
    B, S, D = h.shape
    proj = h @ w_in
    off = 0
    qa = proj[..., off:off + DA_QK_W].reshape(B, S, DA_HEADS, 2, HEAD_DIM); off += DA_QK_W
    ka = proj[..., off:off + DA_QK_W].reshape(B, S, DA_HEADS, 2, HEAD_DIM); off += DA_QK_W
    va = proj[..., off:off + DA_V_W].reshape(B, S, DA_HEADS, DA_V_DIM); off += DA_V_W
    y_a = diff_attention(apply_rope(qa, cos, sin), apply_rope(ka, cos, sin), va,
                         lam_q1, lam_k1, lam_q2, lam_k2, subln_g, lambda_init)
    outs, lses = [], []
    for window, dilation in DIL_PAIRS:
        qg = proj[..., off:off + DIL_W].reshape(B, S, DIL_HEADS, HEAD_DIM); off += DIL_W
        kg = proj[..., off:off + DIL_W].reshape(B, S, DIL_HEADS, HEAD_DIM); off += DIL_W
        vg = proj[..., off:off + DIL_W].reshape(B, S, DIL_HEADS, HEAD_DIM); off += DIL_W
        o, lse = dilated_group(apply_rope(qg, cos, sin), apply_rope(kg, cos, sin), vg, window, dilation)
        outs.append(o)
        lses.append(lse)
    wts = jax.nn.softmax(jnp.stack(lses, axis=0), axis=0)
    y_b = jnp.sum(wts[..., None].astype(h.dtype) * jnp.stack(outs, axis=0), axis=0).reshape(B, S, DIL_W)
    gates = jax.nn.sigmoid(proj[..., off:off + 2 * D] + b_gate)
    merged = gates[..., :D] * (y_a @ w_oa) + gates[..., D:] * (y_b @ w_ob)
    return merged @ w_o


def moe_ffn(h, w_router, b_router, w_gu, b_gu, w_down, b_down):
    B, S, D = h.shape
    T = B * S
    xt = h.reshape(T, D)
    logits = (xt @ w_router).astype(jnp.float32) + b_router.astype(jnp.float32)
    top_val, top_idx = lax.top_k(logits, TOP_K)
    gate_w = jax.nn.softmax(top_val, axis=-1)
    n_assign = T * TOP_K
    flat_e = top_idx.reshape(-1).astype(jnp.int32)
    flat_tok = jnp.arange(n_assign, dtype=jnp.int32) // TOP_K
    flat_w = gate_w.reshape(-1)
    order = jnp.argsort(flat_e)
    sorted_e = flat_e[order]
    counts = jnp.bincount(flat_e, length=N_EXPERTS).astype(jnp.int32)
    padded = (counts + MOE_BLK - 1) // MOE_BLK * MOE_BLK
    ustart = jnp.cumsum(counts) - counts
    pend = jnp.cumsum(padded)
    pstart = pend - padded
    dest = pstart[sorted_e] + (jnp.arange(n_assign, dtype=jnp.int32) - ustart[sorted_e])
    n_rows = n_assign + N_EXPERTS * MOE_BLK
    n_blocks = n_rows // MOE_BLK
    row_tok = jnp.zeros((n_rows,), jnp.int32).at[dest].set(flat_tok[order])
    row_w = jnp.zeros((n_rows,), jnp.float32).at[dest].set(flat_w[order])
    block_e = jnp.minimum(jnp.searchsorted(pend, jnp.arange(n_blocks, dtype=jnp.int32) * MOE_BLK, side='right'),
                          N_EXPERTS - 1)
    xrows = xt[row_tok].reshape(n_blocks, MOE_BLK, D)

    def expert_block(args):
        xb, e = args
        gu = xb @ w_gu[e] + b_gu[e]
        gate = jnp.minimum(gu[:, :D_FF], SWIGLU_LIMIT)
        up = jnp.clip(gu[:, D_FF:], -SWIGLU_LIMIT, SWIGLU_LIMIT)
        act = (up + 1.0) * gate * jax.nn.sigmoid(SWIGLU_ALPHA * gate)
        return act @ w_down[e] + b_down[e]

    yrows = lax.map(expert_block, (xrows, block_e)).reshape(n_rows, D)
    y = jnp.zeros((T, D), jnp.float32).at[row_tok].add(yrows.astype(jnp.float32) * row_w[:, None])
    return y.astype(h.dtype).reshape(B, S, D)


def setup_inputs(seed: int = 0) -> dict:
    key = jax.random.key(seed)
    ks = jax.random.split(key, 24)
    f32 = jnp.float32
    L = DEPTH

    def nrm(k, shape, scale):
        return jax.random.normal(k, shape, f32) * scale

    return {
        "x": nrm(ks[0], (BATCH, SEQ, D_MODEL), 1.0),
        "w_in": nrm(ks[1], (L, D_MODEL, IN_COLS), D_MODEL ** -0.5),
        "b_gate": nrm(ks[2], (L, 2 * D_MODEL), 0.02),
        "lam_q1": nrm(ks[3], (L, HEAD_DIM), 0.1),
        "lam_k1": nrm(ks[4], (L, HEAD_DIM), 0.1),
        "lam_q2": nrm(ks[5], (L, HEAD_DIM), 0.1),
        "lam_k2": nrm(ks[6], (L, HEAD_DIM), 0.1),
        "subln_g": 1.0 + nrm(ks[7], (L, DA_V_DIM), 0.02),
        "w_oa": nrm(ks[8], (L, DA_V_W, D_MODEL), DA_V_W ** -0.5),
        "w_ob": nrm(ks[9], (L, DIL_W, D_MODEL), DIL_W ** -0.5),
        "w_o": nrm(ks[10], (L, D_MODEL, D_MODEL), DN_BETA * D_MODEL ** -0.5),
        "ln1_g": 1.0 + nrm(ks[11], (L, D_MODEL), 0.02),
        "ln1_b": nrm(ks[12], (L, D_MODEL), 0.02),
        "w_router": nrm(ks[13], (L, D_MODEL, N_EXPERTS), D_MODEL ** -0.5),
        "b_router": nrm(ks[14], (L, N_EXPERTS), 0.01),
        "w_gu": nrm(ks[15], (L, N_EXPERTS, D_MODEL, 2 * D_FF), D_MODEL ** -0.5),
        "b_gu": nrm(ks[16], (L, N_EXPERTS, 2 * D_FF), 0.02),
        "w_down": nrm(ks[17], (L, N_EXPERTS, D_FF, D_MODEL), DN_BETA * D_FF ** -0.5),
        "b_down": nrm(ks[18], (L, N_EXPERTS, D_MODEL), 0.02),
        "ln2_g": 1.0 + nrm(ks[19], (L, D_MODEL), 0.02),
        "ln2_b": nrm(ks[20], (L, D_MODEL), 0.02),
    }


def reference(x, w_in, b_gate, lam_q1, lam_k1, lam_q2, lam_k2, subln_g, w_oa, w_ob, w_o,
              ln1_g, ln1_b, w_router, b_router, w_gu, b_gu, w_down, b_down, ln2_g, ln2_b):
    cos, sin = rope_tables(x.shape[1])
    h = x
    for l in range(DEPTH):
        lambda_init = 0.8 - 0.6 * math.exp(-0.3 * l)
        m = token_mixer(h, w_in[l], b_gate[l], lam_q1[l], lam_k1[l], lam_q2[l], lam_k2[l], subln_g[l],
                        w_oa[l], w_ob[l], w_o[l], cos, sin, lambda_init)
        h = layer_norm(DN_ALPHA * h + m, ln1_g[l], ln1_b[l])
        f = moe_ffn(h, w_router[l], b_router[l], w_gu[l], b_gu[l], w_down[l], b_down[l])
        h = layer_norm(DN_ALPHA * h + f, ln2_g[l], ln2_b[l])
    return h
```

```cpp
#include <hip/hip_runtime.h>
#include <cstdio>
#include <cstdint>
#include <cstring>

typedef unsigned short bf16;
typedef unsigned v4u __attribute__((ext_vector_type(4)));
typedef unsigned v2u __attribute__((ext_vector_type(2)));
typedef float f32x4 __attribute__((ext_vector_type(4)));

constexpr int BATCH = 4, SEQ = 4096, DM = 1024, T = BATCH * SEQ;
constexpr int INC = 8192;
constexpr int NE = 32, TOPK = 4, NSLOT = T * TOPK;
constexpr int ACT_ROWS = NSLOT + NE * 256;
constexpr float DN_ALPHA = 1.189207115002721f;
constexpr float EPS = 1e-5f;
constexpr float QSCALE = 0.125f * 1.4426950408889634f;
constexpr float LN2F = 0.6931471805599453f;
constexpr int C_QA = 0, C_KA = 512, C_VA = 1024, C_DIL = 1536, C_GATE = 6144;
__constant__ double c_inv_freq[8] = {1.0, 0.19392274474868576, 0.03760603093086393, 0.007292664737217109,
                                     0.001414213562373095, 0.0002742481756762073, 5.318295896944988e-05, 1.031338537721246e-05};

constexpr size_t MiB = 1u << 20;
constexpr size_t WS_CTL = 0;
constexpr size_t WS_WIN = 1 * MiB;
constexpr size_t WS_WOA = 17 * MiB;
constexpr size_t WS_WOB = 18 * MiB;
constexpr size_t WS_WO = 19 * MiB;
constexpr size_t WS_ROPE = 21 * MiB;
constexpr size_t WS_LIST = 22 * MiB;
constexpr size_t WS_WSLOT = 24 * MiB;
constexpr size_t WS_LSE = 25 * MiB;
constexpr size_t WS_WGU = 32 * MiB;
constexpr size_t WS_WDN = 160 * MiB;
constexpr size_t WS_XB = 224 * MiB;
constexpr size_t WS_PROJ = 256 * MiB;
constexpr size_t WS_OA = 512 * MiB;
constexpr size_t WS_OB = 544 * MiB;
constexpr size_t WS_ACT = WS_PROJ;
constexpr size_t WS_YBUF = WS_PROJ + 144 * MiB;
constexpr size_t WS_YA = 592 * MiB;
constexpr size_t WS_YB = 608 * MiB;
constexpr size_t WS_MG = 624 * MiB;
constexpr size_t WS_H1 = 656 * MiB;
constexpr size_t WS_H1B = 720 * MiB;
constexpr size_t WS_END = 752 * MiB;
static_assert(WS_YBUF + (size_t)NSLOT * DM * 2 <= WS_YA, "ybuf overlay");
static_assert(WS_ACT + (size_t)ACT_ROWS * DM * 2 <= WS_YBUF, "act overlay");
constexpr int CW_CNT = 64;
constexpr int CW_ROWBASE = 4096;

__device__ __forceinline__ unsigned f2bf(float f) { unsigned u = __builtin_bit_cast(unsigned, f); return (u + 0x7fffu + ((u >> 16) & 1u)) >> 16; }
__device__ __forceinline__ float bf2f(unsigned h) { return __builtin_bit_cast(float, h << 16); }
__device__ __forceinline__ unsigned pk2(float lo, float hi) { return f2bf(lo) | (f2bf(hi) << 16); }
__device__ __forceinline__ float wave_sum(float v) {
#pragma unroll
    for (int o = 1; o < 64; o <<= 1) v += __shfl_xor(v, o);
    return v;
}
__device__ __forceinline__ float wave_max(float v) {
#pragma unroll
    for (int o = 1; o < 64; o <<= 1) v = fmaxf(v, __shfl_xor(v, o));
    return v;
}
__device__ __forceinline__ float sigmoidf_(float v) { return 1.f / (1.f + __expf(-v)); }

struct Params {
    const float *x, *w_in, *b_gate, *lam_q1, *lam_k1, *lam_q2, *lam_k2, *subln_g, *w_oa, *w_ob, *w_o, *ln1_g, *ln1_b,
        *w_router, *b_router, *w_gu, *b_gu, *w_down, *b_down, *ln2_g, *ln2_b;
    float* out; unsigned char* ws;
};
#define WSP(type, off) ((type*)(p.ws + (off)))

__device__ __forceinline__ int gu_row(int n) { return n < 1024 ? ((n >> 7) * 256 + (n & 127)) : (((n - 1024) >> 7) * 256 + 128 + ((n - 1024) & 127)); }
struct TrArgs { const float* W; bf16* WT; size_t src_stride, dst_stride; int K, N, mode, pad; };
__global__ void __launch_bounds__(256) k_transpose(TrArgs a) {
    __shared__ float tile[32][33];
    const float* W = a.W + (size_t)blockIdx.z * a.src_stride; bf16* WT = a.WT + (size_t)blockIdx.z * a.dst_stride; const int K = a.K, N = a.N, mode = a.mode;
    const int k0 = blockIdx.y * 32, n0 = blockIdx.x * 32, tx = threadIdx.x & 31, ty = threadIdx.x >> 5;
    for (int i = ty; i < 32; i += 8) tile[i][tx] = W[(size_t)(k0 + i) * N + n0 + tx];
    __syncthreads();
    for (int i = ty; i < 32; i += 8) { const int n = n0 + i; const int r = mode == 1 ? gu_row(n) : n; WT[(size_t)r * K + k0 + tx] = (bf16)f2bf(tile[tx][i]); }
}
__global__ void __launch_bounds__(256) k_convert_x(const float* __restrict__ x, bf16* __restrict__ xb, int n4) {
    for (int i = blockIdx.x * 256 + threadIdx.x; i < n4; i += gridDim.x * 256) { const f32x4 v = ((const f32x4*)x)[i]; v2u o; o.x = pk2(v.x, v.y); o.y = pk2(v.z, v.w); ((v2u*)xb)[i] = o; }
}
__global__ void __launch_bounds__(256) k_rope_table(float* tab) {
    const int i = blockIdx.x * 256 + threadIdx.x; if (i >= SEQ * 8) return;
    const int pos = i >> 3, f = i & 7; const double ang = (double)pos * c_inv_freq[f];
    tab[2 * i] = (float)cos(ang); tab[2 * i + 1] = (float)sin(ang);
}

struct NaiveG { const bf16* A; const int* arow; const bf16* Bt; const unsigned* cnt; const unsigned* rowbase; size_t bt_stride; int lda, M, N, K, list_stride, a_by_rowbase; };
static NaiveG mkg(const bf16* A, int lda, const int* arow, const bf16* Bt, int M, int N, int K, const unsigned* cnt, const unsigned* rowbase, int list_stride, size_t bt_stride, int a_by_rowbase) {
    NaiveG g; memset(&g, 0, sizeof(g)); g.A = A; g.lda = lda; g.arow = arow; g.Bt = Bt; g.M = M; g.N = N; g.K = K; g.cnt = cnt; g.rowbase = rowbase; g.list_stride = list_stride; g.bt_stride = bt_stride; g.a_by_rowbase = a_by_rowbase; return g; }
template <class F, bool DUAL> __global__ void __launch_bounds__(256) naive_gemm(NaiveG g, F f) {
    __shared__ float As[32][68], B1[32][68], B2[DUAL ? 32 : 1][68];
    const int z = blockIdx.z; int M = g.M; const bf16* A = g.A; const int* arow = g.arow; const bf16* Bt = g.Bt + (size_t)z * g.bt_stride;
    if (g.cnt) { M = (int)g.cnt[64 * z]; if (arow) arow += (size_t)z * g.list_stride; if (g.a_by_rowbase) A += (size_t)g.rowbase[z] * g.lda; }
    const int m0 = blockIdx.y * 64, n0 = blockIdx.x * 64; if (m0 >= M) return;
    const int tid = threadIdx.x, tx = tid & 15, ty = tid >> 4, lr = tid >> 2, lk = (tid & 3) * 8;
    int ar = m0 + lr; if (ar >= M) ar = M - 1; if (arow) ar = arow[ar] >> 2;
    const bf16* ap = A + (size_t)ar * g.lda + lk;
    const bf16* bp1 = Bt + (size_t)f.col1(n0 + lr) * g.K + lk;
    const bf16* bp2 = Bt + (size_t)f.col2(n0 + lr) * g.K + lk;
    float acc1[4][4], acc2[4][4];
#pragma unroll
    for (int i = 0; i < 4; ++i)
#pragma unroll
        for (int j = 0; j < 4; ++j) { acc1[i][j] = 0.f; acc2[i][j] = 0.f; }
    for (int k0 = 0; k0 < g.K; k0 += 32) {
        const v4u av = *(const v4u*)(ap + k0), bv = *(const v4u*)(bp1 + k0); v4u cv = bv; if (DUAL) cv = *(const v4u*)(bp2 + k0);
        __syncthreads();
#pragma unroll
        for (int e = 0; e < 4; ++e) {
            As[lk + 2 * e][lr] = bf2f(av[e] & 0xffffu); As[lk + 2 * e + 1][lr] = bf2f(av[e] >> 16);
            B1[lk + 2 * e][lr] = bf2f(bv[e] & 0xffffu); B1[lk + 2 * e + 1][lr] = bf2f(bv[e] >> 16);
            if (DUAL) { B2[lk + 2 * e][lr] = bf2f(cv[e] & 0xffffu); B2[lk + 2 * e + 1][lr] = bf2f(cv[e] >> 16); }
        }
        __syncthreads();
#pragma unroll 8
        for (int k = 0; k < 32; ++k) {
            const f32x4 a = *(const f32x4*)&As[k][ty * 4], b = *(const f32x4*)&B1[k][tx * 4]; f32x4 c = b; if (DUAL) c = *(const f32x4*)&B2[k][tx * 4];
#pragma unroll
            for (int i = 0; i < 4; ++i)
#pragma unroll
                for (int j = 0; j < 4; ++j) { acc1[i][j] += a[i] * b[j]; if (DUAL) acc2[i][j] += a[i] * c[j]; }
        }
    }
#pragma unroll
    for (int i = 0; i < 4; ++i) { const int r = m0 + ty * 4 + i; if (r < M) {
#pragma unroll
            for (int j = 0; j < 4; ++j) f(z, r, n0 + tx * 4 + j, acc1[i][j], acc2[i][j]); } }
}

struct F_proj {
    bf16* proj; const float* rope; const float* b_gate;
    __device__ __forceinline__ static int kind(int c) {
        if (c >= C_GATE) return 3; if (c < C_KA) return 0; if (c < C_VA) return 1; if (c < C_DIL) return 2;
        const int s = ((c - C_DIL) >> 9) % 3; return s; }
    __device__ __forceinline__ int col1(int c) const { return c; }
    __device__ __forceinline__ int col2(int c) const { const int kd = kind(c); return (kd <= 1 && (c & 63) < 16) ? (c ^ 8) : c; }
    __device__ __forceinline__ void operator()(int, int r, int c, float a, float a2) const {
        const int kd = kind(c); float v = a;
        if (kd <= 1 && (c & 63) < 16) { const int pos = r & (SEQ - 1), i = c & 7; const float cs = rope[(pos * 8 + i) * 2], sn = rope[(pos * 8 + i) * 2 + 1];
            v = ((c & 8) == 0) ? (a * cs - a2 * sn) : (a * cs + a2 * sn); }
        if (kd == 0) v *= QSCALE;
        if (kd == 3) v = sigmoidf_(v + b_gate[c - C_GATE]);
        proj[(size_t)r * INC + c] = (bf16)f2bf(v);
    }
};
struct F_mg {
    bf16* mg; const bf16* proj; int gate_off; int first;
    __device__ __forceinline__ int col1(int c) const { return c; }
    __device__ __forceinline__ int col2(int c) const { return c; }
    __device__ __forceinline__ void operator()(int, int r, int c, float a, float) const {
        float v = bf2f(proj[(size_t)r * INC + gate_off + c]) * a; if (!first) v += bf2f(mg[(size_t)r * DM + c]);
        mg[(size_t)r * DM + c] = (bf16)f2bf(v);
    }
};
struct F_wo {
    float* h1; const float* x;
    __device__ __forceinline__ int col1(int c) const { return c; }
    __device__ __forceinline__ int col2(int c) const { return c; }
    __device__ __forceinline__ void operator()(int, int r, int c, float a, float) const { h1[(size_t)r * DM + c] = DN_ALPHA * x[(size_t)r * DM + c] + a; }
};
struct F_gu {
    bf16* act; const float* b_gu; const unsigned* rowbase;
    __device__ __forceinline__ int col1(int c) const { return (c >> 7) * 256 + (c & 127); }
    __device__ __forceinline__ int col2(int c) const { return (c >> 7) * 256 + 128 + (c & 127); }
    __device__ __forceinline__ void operator()(int z, int r, int c, float a, float a2) const {
        float gate = a + b_gu[(size_t)z * 2048 + c], up = a2 + b_gu[(size_t)z * 2048 + 1024 + c];
        gate = fminf(gate, 7.f); up = fminf(fmaxf(up, -7.f), 7.f);
        const float v = (up + 1.f) * gate * sigmoidf_(1.702f * gate);
        act[(size_t)(rowbase[z] + r) * DM + c] = (bf16)f2bf(v);
    }
};
struct F_dn {
    bf16* ybuf; const float* b_down; const int* list; const float* wslot;
    __device__ __forceinline__ int col1(int c) const { return c; }
    __device__ __forceinline__ int col2(int c) const { return c; }
    __device__ __forceinline__ void operator()(int z, int r, int c, float a, float) const {
        const int slot = list[(size_t)z * T + r]; ybuf[(size_t)slot * DM + c] = (bf16)f2bf((a + b_down[(size_t)z * DM + c]) * wslot[slot]);
    }
};

__global__ void __launch_bounds__(64) naive_diff_attn(Params p) {
    __shared__ float qs[128]; __shared__ float as_[64];
    const bf16* proj = WSP(const bf16, WS_PROJ); bf16* ya = WSP(bf16, WS_YA);
    const int lane = threadIdx.x, h = blockIdx.x & 3, t = blockIdx.x >> 2, b = t / SEQ, pos = t % SEQ;
    float l1 = p.lam_q1[lane] * p.lam_k1[lane], l2 = p.lam_q2[lane] * p.lam_k2[lane];
    const float lam = __expf(wave_sum(l1)) - __expf(wave_sum(l2)) + 0.2f;
    const bf16* qrow = proj + (size_t)t * INC + C_QA + h * 128;
    qs[lane] = bf2f(qrow[lane]); qs[64 + lane] = bf2f(qrow[64 + lane]);
    __syncthreads();
    const bf16* kbase = proj + (size_t)b * SEQ * INC + C_KA + h * 128;
    const bf16* vbase = proj + (size_t)b * SEQ * INC + C_VA + h * 128;
    float m0 = -INFINITY, m1 = -INFINITY, s0 = 0.f, s1 = 0.f;
    for (int j = lane; j <= pos; j += 64) {
        const bf16* kr = kbase + (size_t)j * INC; float d0 = 0.f, d1 = 0.f;
        for (int e = 0; e < 64; ++e) { d0 += qs[e] * bf2f(kr[e]); d1 += qs[64 + e] * bf2f(kr[64 + e]); }
        if (d0 > m0) { s0 = s0 * exp2f(m0 - d0) + 1.f; m0 = d0; } else s0 += exp2f(d0 - m0);
        if (d1 > m1) { s1 = s1 * exp2f(m1 - d1) + 1.f; m1 = d1; } else s1 += exp2f(d1 - m1);
    }
    const float M0 = wave_max(m0), M1 = wave_max(m1);
    s0 = (m0 == -INFINITY) ? 0.f : s0 * exp2f(m0 - M0); s1 = (m1 == -INFINITY) ? 0.f : s1 * exp2f(m1 - M1);
    const float L0 = wave_sum(s0), L1 = wave_sum(s1);
    float o0 = 0.f, o1 = 0.f;
    for (int j0 = 0; j0 <= pos; j0 += 64) {
        const int j = j0 + lane; float a = 0.f;
        if (j <= pos) { const bf16* kr = kbase + (size_t)j * INC; float d0 = 0.f, d1 = 0.f;
            for (int e = 0; e < 64; ++e) { d0 += qs[e] * bf2f(kr[e]); d1 += qs[64 + e] * bf2f(kr[64 + e]); }
            a = exp2f(d0 - M0) / L0 - lam * exp2f(d1 - M1) / L1; }
        __syncthreads(); as_[lane] = a; __syncthreads();
        const int n = min(64, pos + 1 - j0);
        for (int jj = 0; jj < n; ++jj) { const bf16* vr = vbase + (size_t)(j0 + jj) * INC; const float aj = as_[jj]; o0 += aj * bf2f(vr[lane]); o1 += aj * bf2f(vr[64 + lane]); }
    }
    const float ms = wave_sum(o0 * o0 + o1 * o1) * (1.f / 128.f), rs = 1.f / sqrtf(ms + EPS) * 0.8f;
    ya[(size_t)t * 512 + h * 128 + lane] = (bf16)f2bf(o0 * rs * p.subln_g[lane]);
    ya[(size_t)t * 512 + h * 128 + 64 + lane] = (bf16)f2bf(o1 * rs * p.subln_g[64 + lane]);
}
__global__ void __launch_bounds__(64) naive_dil_attn(Params p) {
    __shared__ float qs[192]; __shared__ float ps[3][132];
    const bf16* proj = WSP(const bf16, WS_PROJ); bf16* yb = WSP(bf16, WS_YB);
    const int lane = threadIdx.x, h = blockIdx.x & 7, t = blockIdx.x >> 3, pos = t % SEQ;
    for (int g = 0; g < 3; ++g) qs[g * 64 + lane] = bf2f(proj[(size_t)t * INC + C_DIL + g * 1536 + h * 64 + lane]);
    __syncthreads();
    float mx = -INFINITY;
    for (int g = 0; g < 3; ++g) { const int d = g == 0 ? 1 : (g == 1 ? 4 : 16);
        for (int j = lane; j <= 128; j += 64) { float s = -INFINITY;
            if (pos - j * d >= 0) { const bf16* kr = proj + (size_t)(t - j * d) * INC + C_DIL + g * 1536 + 512 + h * 64; s = 0.f; for (int e = 0; e < 64; ++e) s += qs[g * 64 + e] * bf2f(kr[e]); }
            ps[g][j] = s; mx = fmaxf(mx, s); } }
    mx = wave_max(mx); __syncthreads();
    float sum = 0.f;
    for (int g = 0; g < 3; ++g) for (int j = lane; j <= 128; j += 64) { const float e = exp2f(ps[g][j] - mx); ps[g][j] = e; sum += e; }
    sum = wave_sum(sum); __syncthreads();
    float o = 0.f;
    for (int g = 0; g < 3; ++g) { const int d = g == 0 ? 1 : (g == 1 ? 4 : 16);
        for (int j = 0; j <= 128; ++j) { if (pos - j * d < 0) break; o += ps[g][j] * bf2f(proj[(size_t)(t - j * d) * INC + C_DIL + g * 1536 + 1024 + h * 64 + lane]); } }
    yb[(size_t)t * 512 + h * 64 + lane] = (bf16)f2bf(o / sum);
}

__global__ void __launch_bounds__(256) k_ln1(Params p) {
    float* h1 = WSP(float, WS_H1); bf16* h1b = WSP(bf16, WS_H1B);
    const int lane = threadIdx.x & 63, gw = blockIdx.x * 4 + (threadIdx.x >> 6), ngw = gridDim.x * 4;
    for (int r = gw; r < T; r += ngw) {
        f32x4* row = (f32x4*)(h1 + (size_t)r * DM) + lane; f32x4 v[4]; float s = 0.f;
#pragma unroll
        for (int j = 0; j < 4; ++j) { v[j] = row[64 * j]; s += (v[j].x + v[j].y) + (v[j].z + v[j].w); }
        const float mean = wave_sum(s) * (1.f / DM); float q = 0.f;
#pragma unroll
        for (int j = 0; j < 4; ++j) { v[j] = v[j] - mean; q += (v[j].x * v[j].x + v[j].y * v[j].y) + (v[j].z * v[j].z + v[j].w * v[j].w); }
        const float rstd = 1.f / sqrtf(wave_sum(q) * (1.f / DM) + EPS);
#pragma unroll
        for (int j = 0; j < 4; ++j) { const f32x4 g = ((const f32x4*)p.ln1_g)[lane + 64 * j], bb = ((const f32x4*)p.ln1_b)[lane + 64 * j]; const f32x4 o = v[j] * rstd * g + bb;
            row[64 * j] = o; v2u w; w.x = pk2(o.x, o.y); w.y = pk2(o.z, o.w); ((v2u*)(h1b + (size_t)r * DM))[lane + 64 * j] = w; }
    }
}
__global__ void __launch_bounds__(512) k_route(Params p) {
    __shared__ int sel_e[64][4]; __shared__ float sel_w[64][4]; __shared__ int sel_rank[64][4]; __shared__ unsigned lcnt[32], lbase[32];
    const float* h1 = WSP(const float, WS_H1); unsigned* ctl = WSP(unsigned, WS_CTL); int* list = WSP(int, WS_LIST); float* wslot = WSP(float, WS_WSLOT);
    const int tid = threadIdx.x, lane = tid & 63, wave = tid >> 6;
    if (tid < 32) lcnt[tid] = 0u;
    __syncthreads();
    const int e = lane & 31, kh = lane >> 5;
    for (int i = 0; i < 8; ++i) {
        const int tl = wave * 8 + i, t = blockIdx.x * 64 + tl; const float* hr = h1 + (size_t)t * DM + kh * 512; const float* wr = p.w_router + (size_t)kh * 512 * NE + e;
        float acc = 0.f;
#pragma unroll 8
        for (int k = 0; k < 512; ++k) acc += hr[k] * wr[(size_t)k * NE];
        acc += __shfl_xor(acc, 32); float lg = acc + p.b_router[e];
        float tv[4]; int ti[4];
#pragma unroll
        for (int r = 0; r < 4; ++r) { float bv = lg; int bi = e;
#pragma unroll
            for (int o = 1; o < 32; o <<= 1) { const float ov = __shfl_xor(bv, o); const int oi = __shfl_xor(bi, o); if (ov > bv || (ov == bv && oi < bi)) { bv = ov; bi = oi; } }
            tv[r] = bv; ti[r] = bi; if (e == bi) lg = -INFINITY; }
        if (lane == 0) { const float m = tv[0]; float ex[4], s = 0.f;
#pragma unroll
            for (int r = 0; r < 4; ++r) { ex[r] = __expf(tv[r] - m); s += ex[r]; }
#pragma unroll
            for (int r = 0; r < 4; ++r) { sel_e[tl][r] = ti[r]; sel_w[tl][r] = ex[r] / s; sel_rank[tl][r] = (int)atomicAdd(&lcnt[ti[r]], 1u); } }
    }
    __syncthreads();
    if (tid < 32) lbase[tid] = lcnt[tid] ? atomicAdd(&ctl[CW_CNT + 64 * tid], lcnt[tid]) : 0u;
    __syncthreads();
    if (tid < 256) { const int tl = tid >> 2, r = tid & 3, ee = sel_e[tl][r], slot = (blockIdx.x * 64 + tl) * 4 + r;
        list[(size_t)ee * T + lbase[ee] + sel_rank[tl][r]] = slot; wslot[slot] = sel_w[tl][r]; }
}
__global__ void k_rowbase(Params p) { unsigned* ctl = WSP(unsigned, WS_CTL); if (threadIdx.x == 0 && blockIdx.x == 0) { unsigned acc = 0; for (int e = 0; e < NE; ++e) { ctl[CW_ROWBASE + e] = acc; acc += (ctl[CW_CNT + 64 * e] + 255u) & ~255u; } ctl[CW_ROWBASE + NE] = acc; } }
__global__ void __launch_bounds__(256) k_final(Params p) {
    const float* h1 = WSP(const float, WS_H1); const bf16* ybuf = WSP(const bf16, WS_YBUF);
    const int lane = threadIdx.x & 63, gw = blockIdx.x * 4 + (threadIdx.x >> 6), ngw = gridDim.x * 4;
    for (int r = gw; r < T; r += ngw) {
        const f32x4* row = (const f32x4*)(h1 + (size_t)r * DM) + lane; f32x4 v[4]; float s = 0.f;
#pragma unroll
        for (int j = 0; j < 4; ++j) { v[j] = row[64 * j] * DN_ALPHA;
#pragma unroll
            for (int k = 0; k < 4; ++k) { const v2u y = ((const v2u*)(ybuf + (size_t)(4 * r + k) * DM))[lane + 64 * j]; v[j].x += bf2f(y.x & 0xffffu); v[j].y += bf2f(y.x >> 16); v[j].z += bf2f(y.y & 0xffffu); v[j].w += bf2f(y.y >> 16); }
            s += (v[j].x + v[j].y) + (v[j].z + v[j].w); }
        const float mean = wave_sum(s) * (1.f / DM); float q = 0.f;
#pragma unroll
        for (int j = 0; j < 4; ++j) { v[j] = v[j] - mean; q += (v[j].x * v[j].x + v[j].y * v[j].y) + (v[j].z * v[j].z + v[j].w * v[j].w); }
        const float rstd = 1.f / sqrtf(wave_sum(q) * (1.f / DM) + EPS);
#pragma unroll
        for (int j = 0; j < 4; ++j) { const f32x4 g = ((const f32x4*)p.ln2_g)[lane + 64 * j], bb = ((const f32x4*)p.ln2_b)[lane + 64 * j];
            ((f32x4*)(p.out + (size_t)r * DM))[lane + 64 * j] = v[j] * rstd * g + bb; }
    }
}

extern "C" void kernel_launch(void* const* d_in, const int* in_sizes, int n_in, void* d_out, int out_size, void* d_ws, size_t ws_size, hipStream_t stream) {
    if (n_in != 21 || ws_size < WS_END || out_size != T * DM) { fprintf(stderr, "kernel_launch: unexpected arguments (n_in %d, ws %zu, out %d)\n", n_in, ws_size, out_size); return; }
    Params p{};
    const float** pp = (const float**)&p;
    for (int i = 0; i < 21; ++i) pp[i] = (const float*)d_in[i];
    p.out = (float*)d_out; p.ws = (unsigned char*)d_ws;
    (void)hipMemsetAsync((char*)d_ws + WS_CTL, 0, 1 * MiB, stream);
    { TrArgs a; memset(&a, 0, sizeof(a)); a.W = p.w_in; a.WT = WSP(bf16, WS_WIN); a.K = DM; a.N = INC; a.mode = 0; a.src_stride = (size_t)0; a.dst_stride = (size_t)0; hipLaunchKernelGGL(k_transpose, dim3(INC / 32, DM / 32, 1), dim3(256), 0, stream, a); }
    { TrArgs a; memset(&a, 0, sizeof(a)); a.W = p.w_oa; a.WT = WSP(bf16, WS_WOA); a.K = 512; a.N = DM; a.mode = 0; a.src_stride = (size_t)0; a.dst_stride = (size_t)0; hipLaunchKernelGGL(k_transpose, dim3(DM / 32, 512 / 32, 1), dim3(256), 0, stream, a); }
    { TrArgs a; memset(&a, 0, sizeof(a)); a.W = p.w_ob; a.WT = WSP(bf16, WS_WOB); a.K = 512; a.N = DM; a.mode = 0; a.src_stride = (size_t)0; a.dst_stride = (size_t)0; hipLaunchKernelGGL(k_transpose, dim3(DM / 32, 512 / 32, 1), dim3(256), 0, stream, a); }
    { TrArgs a; memset(&a, 0, sizeof(a)); a.W = p.w_o; a.WT = WSP(bf16, WS_WO); a.K = DM; a.N = DM; a.mode = 0; a.src_stride = (size_t)0; a.dst_stride = (size_t)0; hipLaunchKernelGGL(k_transpose, dim3(DM / 32, DM / 32, 1), dim3(256), 0, stream, a); }
    { TrArgs a; memset(&a, 0, sizeof(a)); a.W = p.w_gu; a.WT = WSP(bf16, WS_WGU); a.K = DM; a.N = 2048; a.mode = 1; a.src_stride = (size_t)DM * 2048; a.dst_stride = (size_t)DM * 2048; hipLaunchKernelGGL(k_transpose, dim3(2048 / 32, DM / 32, NE), dim3(256), 0, stream, a); }
    { TrArgs a; memset(&a, 0, sizeof(a)); a.W = p.w_down; a.WT = WSP(bf16, WS_WDN); a.K = DM; a.N = DM; a.mode = 0; a.src_stride = (size_t)DM * DM; a.dst_stride = (size_t)DM * DM; hipLaunchKernelGGL(k_transpose, dim3(DM / 32, DM / 32, NE), dim3(256), 0, stream, a); }
    hipLaunchKernelGGL(k_convert_x, dim3(2048), dim3(256), 0, stream, p.x, WSP(bf16, WS_XB), T * DM / 4);
    hipLaunchKernelGGL(k_rope_table, dim3(SEQ * 8 / 256), dim3(256), 0, stream, WSP(float, WS_ROPE));
    { NaiveG g = mkg(WSP(const bf16, WS_XB), DM, nullptr, WSP(const bf16, WS_WIN), T, INC, DM, nullptr, nullptr, 0, 0, 0);
      F_proj f{WSP(bf16, WS_PROJ), WSP(const float, WS_ROPE), p.b_gate};
      hipLaunchKernelGGL((naive_gemm<F_proj, true>), dim3(INC / 64, T / 64, 1), dim3(256), 0, stream, g, f); }
    hipLaunchKernelGGL(naive_diff_attn, dim3(T * 4), dim3(64), 0, stream, p);
    hipLaunchKernelGGL(naive_dil_attn, dim3(T * 8), dim3(64), 0, stream, p);
    { NaiveG g = mkg(WSP(const bf16, WS_YA), 512, nullptr, WSP(const bf16, WS_WOA), T, DM, 512, nullptr, nullptr, 0, 0, 0);
      F_mg f{WSP(bf16, WS_MG), WSP(const bf16, WS_PROJ), C_GATE, 1};
      hipLaunchKernelGGL((naive_gemm<F_mg, false>), dim3(DM / 64, T / 64, 1), dim3(256), 0, stream, g, f); }
    { NaiveG g = mkg(WSP(const bf16, WS_YB), 512, nullptr, WSP(const bf16, WS_WOB), T, DM, 512, nullptr, nullptr, 0, 0, 0);
      F_mg f{WSP(bf16, WS_MG), WSP(const bf16, WS_PROJ), C_GATE + 1024, 0};
      hipLaunchKernelGGL((naive_gemm<F_mg, false>), dim3(DM / 64, T / 64, 1), dim3(256), 0, stream, g, f); }
    { NaiveG g = mkg(WSP(const bf16, WS_MG), DM, nullptr, WSP(const bf16, WS_WO), T, DM, DM, nullptr, nullptr, 0, 0, 0);
      F_wo f{WSP(float, WS_H1), p.x};
      hipLaunchKernelGGL((naive_gemm<F_wo, false>), dim3(DM / 64, T / 64, 1), dim3(256), 0, stream, g, f); }
    hipLaunchKernelGGL(k_ln1, dim3(1024), dim3(256), 0, stream, p);
    hipLaunchKernelGGL(k_route, dim3(T / 64), dim3(512), 0, stream, p);
    hipLaunchKernelGGL(k_rowbase, dim3(1), dim3(64), 0, stream, p);
    { NaiveG g = mkg(WSP(const bf16, WS_H1B), DM, WSP(const int, WS_LIST), WSP(const bf16, WS_WGU), 0, DM, DM, WSP(const unsigned, WS_CTL) + CW_CNT, WSP(const unsigned, WS_CTL) + CW_ROWBASE, T, (size_t)2048 * DM, 0);
      F_gu f{WSP(bf16, WS_ACT), p.b_gu, WSP(const unsigned, WS_CTL) + CW_ROWBASE};
      hipLaunchKernelGGL((naive_gemm<F_gu, true>), dim3(DM / 64, T / 64, NE), dim3(256), 0, stream, g, f); }
    { NaiveG g = mkg(WSP(const bf16, WS_ACT), DM, nullptr, WSP(const bf16, WS_WDN), 0, DM, DM, WSP(const unsigned, WS_CTL) + CW_CNT, WSP(const unsigned, WS_CTL) + CW_ROWBASE, T, (size_t)DM * DM, 1);
      F_dn f{WSP(bf16, WS_YBUF), p.b_down, WSP(const int, WS_LIST), WSP(const float, WS_WSLOT)};
      hipLaunchKernelGGL((naive_gemm<F_dn, false>), dim3(DM / 64, T / 64, NE), dim3(256), 0, stream, g, f); }
    hipLaunchKernelGGL(k_final, dim3(1024), dim3(256), 0, stream, p);
}
```
